# Optimizing an MI355X kernel written in HIP

```python
import jax, jax.numpy as jnp
from jax import lax
import numpy as np

D_MODEL = 1024
BATCH = 8
SEQ = 2048
DEPTH = 2

CONV_DIM = 512
CONV_WIDTH = 3
RET_HEADS = 4
RET_HEAD_DIM = 128
RET_DIM = RET_HEADS * RET_HEAD_DIM
GLA_HEADS = 4
GLA_KEY_HEAD_DIM = 64
GLA_VAL_HEAD_DIM = 128
GLA_KEY_DIM = GLA_HEADS * GLA_KEY_HEAD_DIM
GLA_VAL_DIM = GLA_HEADS * GLA_VAL_HEAD_DIM
GLA_GATE_RANK = 16
GLA_GATE_TAU = 16.0
N_BRANCHES = 3
CHUNK = 64
D_FF = (((8 * D_MODEL + 2) // 3 + 255) // 256) * 256
ROPE_BASE = 10000.0
EPS = 1e-6
IN_COLS = 3 * CONV_DIM + 4 * RET_DIM + 2 * GLA_KEY_DIM + 2 * GLA_VAL_DIM + GLA_GATE_RANK + N_BRANCHES * D_MODEL

kernel_name = "hybrid_conv_retention_gla_gated_block"


def rms_norm(x, w):
    xf = x.astype(jnp.float32)
    y = xf * lax.rsqrt(jnp.mean(xf * xf, axis=-1, keepdims=True) + EPS)
    return (y * w.astype(jnp.float32)).astype(x.dtype)


def head_norm(y, w, center):
    b, t, h, d = y.shape
    if center:
        y = y - jnp.mean(y, axis=-1, keepdims=True)
    y = y * lax.rsqrt(jnp.mean(y * y, axis=-1, keepdims=True) + EPS)
    return y.reshape(b, t, h * d) * w.astype(jnp.float32)


def rotary(x, positions):
    half = x.shape[-1] // 2
    inv_freq = ROPE_BASE ** (-jnp.arange(half, dtype=jnp.float32) / half)
    ang = positions.astype(jnp.float32)[..., None] * inv_freq
    cos = jnp.cos(ang)[:, :, None, :]
    sin = jnp.sin(ang)[:, :, None, :]
    x1, x2 = x[..., :half], x[..., half:]
    return jnp.concatenate([x1 * cos - x2 * sin, x2 * cos + x1 * sin], axis=-1)


def to_chunks(x):
    b, t, h, d = x.shape
    return x.reshape(b, t // CHUNK, CHUNK, h, d).transpose(1, 0, 3, 2, 4)


def from_chunks(x):
    nc, b, h, c, d = x.shape
    return x.transpose(1, 0, 3, 2, 4).reshape(b, nc * c, h, d)


def short_conv(u, b_gate, c_gate, conv_w):
    z = c_gate * u
    t = z.shape[1]
    zp = jnp.pad(z, ((0, 0), (CONV_WIDTH - 1, 0), (0, 0)))
    y = sum(conv_w[i] * zp[:, i:i + t, :] for i in range(CONV_WIDTH))
    return b_gate * y


def retention(q, k, v):
    b, t, h, dk = q.shape
    dv = v.shape[-1]
    log_g = jnp.log(1.0 - 2.0 ** (-5.0 - jnp.arange(h, dtype=jnp.float32)))
    idx = jnp.arange(CHUNK, dtype=jnp.float32)
    diff = idx[:, None] - idx[None, :]
    causal = diff >= 0
    decay_mask = jnp.where(causal, jnp.exp(log_g[:, None, None] * jnp.maximum(diff, 0.0)), 0.0)
    q_decay = jnp.exp(log_g[:, None] * (idx + 1.0))[None, :, :, None]
    k_decay = jnp.exp(log_g[:, None] * (CHUNK - 1.0 - idx))[None, :, :, None]
    chunk_decay = jnp.exp(log_g * CHUNK)[None, :, None, None]
    q = q * (dk ** -0.5)

    def step(state, inp):
        qi, ki, vi = inp
        s = jnp.einsum('bhid,bhjd->bhij', qi, ki) * decay_mask
        intra = jnp.einsum('bhij,bhjv->bhiv', s, vi)
        inter = jnp.einsum('bhid,bhdv->bhiv', qi * q_decay, state)
        new_state = state * chunk_decay + jnp.einsum('bhjd,bhjv->bhdv', ki * k_decay, vi)
        return new_state, intra + inter

    state0 = jnp.zeros((b, h, dk, dv), jnp.float32)
    _, out = lax.scan(step, state0, (to_chunks(q), to_chunks(k), to_chunks(v)))
    return from_chunks(out)


def gated_linear_attention(q, k, v, log_a):
    b, t, h, dk = q.shape
    dv = v.shape[-1]
    q = q * (dk ** -0.5)
    tril = jnp.tril(jnp.ones((CHUNK, CHUNK), dtype=bool))[None, None, :, :, None]

    def step(state, inp):
        qi, ki, vi, gi = inp
        cum = jnp.cumsum(gi, axis=2)
        rel = cum[:, :, :, None, :] - cum[:, :, None, :, :]
        pair_decay = jnp.where(tril, jnp.exp(jnp.where(tril, rel, 0.0)), 0.0)
        s = jnp.einsum('bhid,bhjd,bhijd->bhij', qi, ki, pair_decay)
        intra = jnp.einsum('bhij,bhjv->bhiv', s, vi)
        inter = jnp.einsum('bhid,bhdv->bhiv', qi * jnp.exp(cum), state)
        last = cum[:, :, -1:, :]
        new_state = state * jnp.exp(last)[:, :, 0, :, None] + jnp.einsum(
            'bhjd,bhjv->bhdv', ki * jnp.exp(last - cum), vi)
        return new_state, intra + inter

    state0 = jnp.zeros((b, h, dk, dv), jnp.float32)
    _, out = lax.scan(step, state0, (to_chunks(q), to_chunks(k), to_chunks(v), to_chunks(log_a)))
    return from_chunks(out)


def split_columns(proj):
    sizes = ([CONV_DIM] * 3 + [RET_DIM] * 4
             + [GLA_KEY_DIM, GLA_KEY_DIM, GLA_VAL_DIM, GLA_VAL_DIM, GLA_GATE_RANK]
             + [D_MODEL] * N_BRANCHES)
    offsets = [int(o) for o in np.cumsum(sizes)[:-1]]
    return jnp.split(proj, offsets, axis=-1)


def mixer_block(h, positions, w_in, conv_w, ret_gn_w, gla_w_a2, gla_b_a, gla_gn_w,
                w_branch_a, w_branch_b, w_branch_c, w_out):
    bsz, t, _ = h.shape
    proj = (h @ w_in).astype(jnp.float32)
    (cu, cb, cc, rq, rk, rv, rg, gq, gk, gv, gr, ga_down,
     gate_a, gate_b, gate_c) = split_columns(proj)

    y_a = short_conv(cu, cb, cc, conv_w.astype(jnp.float32))

    rq = rotary(rq.reshape(bsz, t, RET_HEADS, RET_HEAD_DIM), positions)
    rk = rotary(rk.reshape(bsz, t, RET_HEADS, RET_HEAD_DIM), positions)
    rv = rv.reshape(bsz, t, RET_HEADS, RET_HEAD_DIM)
    y_b = head_norm(retention(rq, rk, rv), ret_gn_w, center=True) * jax.nn.silu(rg)

    gate_logits = ga_down @ gla_w_a2.astype(jnp.float32) + gla_b_a.astype(jnp.float32)
    log_a = (jax.nn.log_sigmoid(gate_logits) / GLA_GATE_TAU).reshape(bsz, t, GLA_HEADS, GLA_KEY_HEAD_DIM)
    gq = gq.reshape(bsz, t, GLA_HEADS, GLA_KEY_HEAD_DIM)
    gk = gk.reshape(bsz, t, GLA_HEADS, GLA_KEY_HEAD_DIM)
    gv = gv.reshape(bsz, t, GLA_HEADS, GLA_VAL_HEAD_DIM)
    y_c = head_norm(gated_linear_attention(gq, gk, gv, log_a), gla_gn_w, center=False) * jax.nn.silu(gr)

    merged = (jax.nn.sigmoid(gate_a) * (y_a @ w_branch_a.astype(jnp.float32))
              + jax.nn.sigmoid(gate_b) * (y_b @ w_branch_b.astype(jnp.float32))
              + jax.nn.sigmoid(gate_c) * (y_c @ w_branch_c.astype(jnp.float32)))
    return (merged @ w_out.astype(jnp.float32)).astype(h.dtype)


def swiglu(h, w_gate, w_up, w_down):
    return (jax.nn.silu(h @ w_gate) * (h @ w_up)) @ w_down


def setup_inputs(seed: int = 0) -> dict:
    key = jax.random.key(seed)
    ks = jax.random.split(key, 20)
    f32 = jnp.float32

    def normal(k, shape, scale):
        return jax.random.normal(k, shape, f32) * scale

    def gain(k, shape):
        return 1.0 + 0.1 * jax.random.normal(k, shape, f32)

    return {
        "x": normal(ks[0], (BATCH, SEQ, D_MODEL), 1.0),
        "positions": jnp.broadcast_to(jnp.arange(SEQ, dtype=jnp.int32), (BATCH, SEQ)),
        "norm_mix_pre": gain(ks[1], (DEPTH, D_MODEL)),
        "w_in": normal(ks[2], (DEPTH, D_MODEL, IN_COLS), D_MODEL ** -0.5),
        "conv_w": normal(ks[3], (DEPTH, CONV_WIDTH, CONV_DIM), CONV_WIDTH ** -0.5),
        "ret_gn_w": gain(ks[4], (DEPTH, RET_DIM)),
        "gla_w_a2": normal(ks[5], (DEPTH, GLA_GATE_RANK, GLA_KEY_DIM), GLA_GATE_RANK ** -0.5),
        "gla_b_a": normal(ks[6], (DEPTH, GLA_KEY_DIM), 0.1),
        "gla_gn_w": gain(ks[7], (DEPTH, GLA_VAL_DIM)),
        "w_branch_a": normal(ks[8], (DEPTH, CONV_DIM, D_MODEL), CONV_DIM ** -0.5),
        "w_branch_b": normal(ks[9], (DEPTH, RET_DIM, D_MODEL), RET_DIM ** -0.5),
        "w_branch_c": normal(ks[10], (DEPTH, GLA_VAL_DIM, D_MODEL), GLA_VAL_DIM ** -0.5),
        "w_out": normal(ks[11], (DEPTH, D_MODEL, D_MODEL), D_MODEL ** -0.5),
        "norm_mix_post": gain(ks[12], (DEPTH, D_MODEL)),
        "norm_ffn_pre": gain(ks[13], (DEPTH, D_MODEL)),
        "w_ffn_gate": normal(ks[14], (DEPTH, D_MODEL, D_FF), D_MODEL ** -0.5),
        "w_ffn_up": normal(ks[15], (DEPTH, D_MODEL, D_FF), D_MODEL ** -0.5),
        "w_ffn_down": normal(ks[16], (DEPTH, D_FF, D_MODEL), D_FF ** -0.5),
        "norm_ffn_post": gain(ks[17], (DEPTH, D_MODEL)),
    }


def reference(x, positions, norm_mix_pre, w_in, conv_w, ret_gn_w, gla_w_a2, gla_b_a, gla_gn_w,
              w_branch_a, w_branch_b, w_branch_c, w_out, norm_mix_post, norm_ffn_pre,
              w_ffn_gate, w_ffn_up, w_ffn_down, norm_ffn_post):
    for layer in range(DEPTH):
        h = rms_norm(x, norm_mix_pre[layer])
        m = mixer_block(h, positions, w_in[layer], conv_w[layer], ret_gn_w[layer], gla_w_a2[layer],
                        gla_b_a[layer], gla_gn_w[layer], w_branch_a[layer], w_branch_b[layer],
                        w_branch_c[layer], w_out[layer])
        x = x + rms_norm(m, norm_mix_post[layer]).astype(x.dtype)
        h = rms_norm(x, norm_ffn_pre[layer])
        f = swiglu(h, w_ffn_gate[layer], w_ffn_up[layer], w_ffn_down[layer])
        x = x + rms_norm(f, norm_ffn_post[layer]).astype(x.dtype)
    return x
```

```cpp
#define MK_N_LAUNCHES 19
#include <hip/hip_runtime.h>
#include <cstdio>
#include <cstdint>
namespace pg8 {
#define PG8_LAS __attribute__((address_space(3)))
typedef unsigned short bf16_t;
typedef short bf16x8 __attribute__((ext_vector_type(8)));
typedef float f32x4 __attribute__((ext_vector_type(4)));
typedef unsigned u32x4 __attribute__((ext_vector_type(4)));
constexpr int BM = 256, BK = 64, HALF = 128, HTB = HALF * BK * 2  , STAGE_BYTES = 8 * HTB, NXCD = 8, WGM = 8;

__host__ __device__ __forceinline__ int lds_byte(int r, int c) { const int st = (r >> 4) * 2 + (c >> 5), rr = r & 15, cc = c & 31, ob = rr * 64 + cc * 2; return st * 1024 + (ob ^ (((ob >> 9) & 1) << 5)); }
__host__ __device__ __forceinline__ void stage_rc(int b, int& R, int& C) { const int st = b / 1024, sb = b % 1024, swz = sb ^ (((sb >> 9) & 1) << 5); R = (st >> 1) * 16 + swz / 64; C = (st & 1) * 32 + (swz % 64) / 2; }
__host__ __device__ __forceinline__ int perm32(int rho) { const int n = rho >> 4, i = rho & 15; return 8 * (i >> 2) + 4 * n + (i & 3); }

struct Unit { int pm, pn; };
struct Gemm { const bf16_t* A; const bf16_t* Bt; int M, N, K; };

struct StaticOrder {
    int nM, nN, nwg, G, c;
    __host__ __device__ void init(int M, int N, int G_, int c_) { nM = M / BM; nN = N / BM; nwg = nM * nN; G = G_; c = c_; }
    __host__ __device__ bool next(int i, Unit& u) const {
        const long L = (long)i * G + c; if (L >= nwg) return false;
        int wgid = (int)L; { const int q = nwg / NXCD, r = nwg % NXCD, xcd = wgid % NXCD, off = wgid / NXCD; wgid = (xcd < r ? xcd * (q + 1) : r * (q + 1) + (xcd - r) * q) + off; }
        const int nig = WGM * nN, gid = wgid / nig, fm = gid * WGM, gsz = (nM - fm) < WGM ? (nM - fm) : WGM;
        u.pm = fm + ((wgid % nig) % gsz); u.pn = (wgid % nig) / gsz; return true;
    }
    __device__ __forceinline__ void a_ready(const Unit&) const {}
    __device__ __forceinline__ void done(const Unit&) const {}
};

__device__ __forceinline__ unsigned cvt_pk_bf16(float lo, float hi) { unsigned r; asm volatile("v_cvt_pk_bf16_f32 %0, %1, %2" : "=v"(r) : "v"(lo), "v"(hi)); return r; }
typedef float f32x2 __attribute__((ext_vector_type(2)));
__device__ __forceinline__ f32x2 gelu_pk(f32x2 v) {
    const f32x2 av = __builtin_elementwise_abs(v), d = av * 0.2316418882f + 1.0f;
    f32x2 t; t.x = __builtin_amdgcn_rcpf(d.x); t.y = __builtin_amdgcn_rcpf(d.y);
    f32x2 q = t * 0.5307027145f + (-0.7265760135f); q = q * t + 0.7107068705f; q = q * t + (-0.142248368f); q = q * t + 0.127414796f; q = q * t;
    const f32x2 s = (v * v) * (-0.72134752044f);
    f32x2 e; e.x = __builtin_amdgcn_exp2f(s.x); e.y = __builtin_amdgcn_exp2f(s.y);
    const f32x2 m = v * (q * e), r = v - m;
    f32x2 o; o.x = v.x < 0.f ? m.x : r.x; o.y = v.y < 0.f ? m.y : r.y; return o;
}

template <int ACT  > struct EpiBf16 {
    static constexpr bool PERM = true, AFTER_DRAIN = false; static_assert(ACT == 0 || ACT == 1, "EpiBf16: ACT is 0 (none) or 1 (gelu_pk)");
    bf16_t* O; int ldc; const float* bias; int split_cols; size_t split_stride; float scale0;
    __device__ __forceinline__ void operator()(const f32x4 (&acc)[2][2][4][2], const Unit& u, int wr, int wc, int fr, int fq) const {
        const int row0 = u.pm * BM + wr * 64 + fr; int colt = u.pn * BM; bf16_t* base = O;
        float sc = 1.f; if (split_cols) { const int t = colt / split_cols; base += (size_t)t * split_stride; colt -= t * split_cols; if (t == 0) sc = scale0; }
        const int col0 = colt + wc * 32 + 8 * fq, bcol0 = u.pn * BM + wc * 32 + 8 * fq;
        f32x4 bv[2][2];
#pragma unroll
        for (int bj = 0; bj < 2; ++bj)
#pragma unroll
            for (int n = 0; n < 2; ++n) bv[bj][n] = bias ? *(const f32x4*)(bias + bcol0 + bj * HALF + 4 * n) : (f32x4){0.f, 0.f, 0.f, 0.f};
#pragma unroll
        for (int ai = 0; ai < 2; ++ai)
#pragma unroll
            for (int m = 0; m < 4; ++m) { bf16_t* rowp = base + (size_t)(row0 + ai * HALF + m * 16) * ldc + col0;
#pragma unroll
                for (int bj = 0; bj < 2; ++bj) { f32x4 v0 = acc[ai][bj][m][0] + bv[bj][0], v1 = acc[ai][bj][m][1] + bv[bj][1];
                    if (ACT == 1) { f32x2 a = gelu_pk((f32x2){v0[0], v0[1]}), b = gelu_pk((f32x2){v0[2], v0[3]}), c = gelu_pk((f32x2){v1[0], v1[1]}), d = gelu_pk((f32x2){v1[2], v1[3]});
                        v0 = (f32x4){a.x, a.y, b.x, b.y}; v1 = (f32x4){c.x, c.y, d.x, d.y}; }
                    v0 = v0 * sc; v1 = v1 * sc; u32x4 w; w.x = cvt_pk_bf16(v0[0], v0[1]); w.y = cvt_pk_bf16(v0[2], v0[3]); w.z = cvt_pk_bf16(v1[0], v1[1]); w.w = cvt_pk_bf16(v1[2], v1[3]);
                    *(u32x4*)(rowp + bj * HALF) = w; } }
    }
};

struct PanelStats {
    unsigned* xbuf;
    unsigned* cnt;
    unsigned* tmo;
    int ntn; float eps;
    unsigned code;
    __device__ __forceinline__ bool run(const f32x4 (&v)[2][2][4][2], const Unit& u, int wr, int wc, int fr, int fq, PG8_LAS unsigned char* lds, int wid, int lane) const {
        typedef float f32x2v __attribute__((ext_vector_type(2)));
        PG8_LAS f32x2v* P = (PG8_LAS f32x2v*)lds;
        PG8_LAS f32x2v* S = (PG8_LAS f32x2v*)(lds + 8192);
        PG8_LAS unsigned* flag = (PG8_LAS unsigned*)(lds + 8192 + 2048);
#pragma unroll
        for (int ai = 0; ai < 2; ++ai)
#pragma unroll
            for (int m = 0; m < 4; ++m) {
                float s = 0.f;
#pragma unroll
                for (int bj = 0; bj < 2; ++bj)
#pragma unroll
                    for (int n = 0; n < 2; ++n) { const f32x4 x = v[ai][bj][m][n]; s += (x[0] + x[1]) + (x[2] + x[3]); }
                s += __shfl_xor(s, 16); s += __shfl_xor(s, 32);
                const float mw = s * (1.0f / 64.0f); float q = 0.f;
#pragma unroll
                for (int bj = 0; bj < 2; ++bj)
#pragma unroll
                    for (int n = 0; n < 2; ++n) { const f32x4 d = v[ai][bj][m][n] - mw; q += (d[0] * d[0] + d[1] * d[1]) + (d[2] * d[2] + d[3] * d[3]); }
                q += __shfl_xor(q, 16); q += __shfl_xor(q, 32);
                if (fq == 0) P[(ai * HALF + wr * 64 + m * 16 + fr) * 4 + wc] = (f32x2v){mw, q};
            }
        asm volatile("s_waitcnt lgkmcnt(0)" ::: "memory"); __builtin_amdgcn_s_barrier(); asm volatile("" ::: "memory");
#if defined(BROKEN_EXCHANGE_NO_WAIT)
#warning BROKEN CONTROL BUILD: the row-statistics exchange does not wait; results are wrong by design
        if (blockIdx.x >= 64) { const long long t0_ = clock64(); while (clock64() - t0_ < 60000) __builtin_amdgcn_s_sleep(8); }
#endif
        const int row = wid * 32 + (lane & 31);
        if (lane < 32) {
            const f32x2v a = P[row * 4 + 0], b = P[row * 4 + 1], c = P[row * 4 + 2], d = P[row * 4 + 3];
            const float mt = (a.x + b.x + c.x + d.x) * 0.25f;
            const float da = a.x - mt, db = b.x - mt, dc = c.x - mt, dd = d.x - mt;
            const float m2 = (a.y + b.y) + (c.y + d.y) + 64.0f * ((da * da + db * db) + (dc * dc + dd * dd));
            unsigned long long* slot = (unsigned long long*)xbuf + ((size_t)(u.pm * BM + row) * 4 + u.pn);
            __hip_atomic_store(slot, ((unsigned long long)__float_as_uint(m2) << 32) | __float_as_uint(mt), __ATOMIC_RELAXED, __HIP_MEMORY_SCOPE_AGENT);
        }
        asm volatile("s_waitcnt vmcnt(0)" ::: "memory");
        if (lane == 0) __hip_atomic_fetch_add(cnt + 64 * u.pm, 1u, __ATOMIC_RELAXED, __HIP_MEMORY_SCOPE_AGENT);
        if (wid == 0) {
            bool dead = false; const unsigned long long t0 = __builtin_amdgcn_s_memrealtime(); const unsigned want = 8u * (unsigned)ntn;
            for (;;) {
#if defined(BROKEN_EXCHANGE_NO_WAIT)
                break;
#endif
                if ((unsigned)__builtin_amdgcn_readfirstlane(__hip_atomic_load(cnt + 64 * u.pm, __ATOMIC_RELAXED, __HIP_MEMORY_SCOPE_AGENT)) >= want) break;
                if (__builtin_amdgcn_s_memrealtime() - t0 > 2000000ull) {
                    if (lane == 0) { unsigned expect = 0u; __hip_atomic_compare_exchange_strong(tmo + 1, &expect, code | (unsigned)(u.pm & 0xff), __ATOMIC_RELAXED, __ATOMIC_RELAXED, __HIP_MEMORY_SCOPE_AGENT);
                                     __hip_atomic_store(tmo, 1u, __ATOMIC_RELAXED, __HIP_MEMORY_SCOPE_AGENT); }
                    dead = true; break; }
                __builtin_amdgcn_s_sleep(2);
            }
            __builtin_amdgcn_fence(__ATOMIC_ACQUIRE, "agent");
            if (lane == 0) flag[0] = dead ? 1u : 0u;
        }
        asm volatile("s_waitcnt vmcnt(0) lgkmcnt(0)" ::: "memory"); __builtin_amdgcn_s_barrier(); asm volatile("" ::: "memory");
        const bool bad = flag[0] != 0u;
        if (lane < 32) {
            const unsigned long long* slot = (const unsigned long long*)xbuf + (size_t)(u.pm * BM + row) * 4; float mt[4], m2[4]; float ms = 0.f;
#pragma unroll
            for (int t = 0; t < 4; ++t) { if (t < ntn) { const unsigned long long w = __hip_atomic_load(slot + t, __ATOMIC_RELAXED, __HIP_MEMORY_SCOPE_AGENT); mt[t] = __uint_as_float((unsigned)w); m2[t] = __uint_as_float((unsigned)(w >> 32)); } else { mt[t] = 0.f; m2[t] = 0.f; } ms += mt[t]; }
            const float mean = ms / (float)ntn; float q = 0.f;
#pragma unroll
            for (int t = 0; t < 4; ++t) if (t < ntn) { const float dm = mt[t] - mean; q += m2[t] + 256.0f * dm * dm; }
            S[row] = (f32x2v){mean, 1.0f / sqrtf(q / (256.0f * (float)ntn) + eps)};
        }
        asm volatile("s_waitcnt lgkmcnt(0)" ::: "memory"); __builtin_amdgcn_s_barrier(); asm volatile("" ::: "memory");
        return bad;
    }
};
struct EpiLnRes {
    static constexpr bool PERM = false, AFTER_DRAIN = true;
    const float* base; float* out; int ldc; const float* bias; PanelStats st; unsigned poison;
    __device__ __forceinline__ void fused(f32x4 (&acc)[2][2][4][2], const Unit& u, int wr, int wc, int fr, int fq, PG8_LAS unsigned char* lds, int wid, int lane) const {
        typedef float f32x2v __attribute__((ext_vector_type(2)));
        const PG8_LAS f32x2v* S = (const PG8_LAS f32x2v*)(lds + 8192);
        const int col0 = u.pn * BM + wc * 32 + 4 * fq;
#pragma unroll
        for (int bj = 0; bj < 2; ++bj)
#pragma unroll
            for (int n = 0; n < 2; ++n) { const f32x4 bv = bias ? *(const f32x4*)(bias + col0 + bj * HALF + n * 16) : (f32x4){0.f, 0.f, 0.f, 0.f};
#pragma unroll
                for (int ai = 0; ai < 2; ++ai)
#pragma unroll
                    for (int m = 0; m < 4; ++m) acc[ai][bj][m][n] += bv; }
        f32x4 pre[4][2][2];
#pragma unroll
        for (int m = 0; m < 4; ++m) { const size_t off = (size_t)(u.pm * BM + wr * 64 + m * 16 + fr) * ldc + col0;
#pragma unroll
            for (int bj = 0; bj < 2; ++bj)
#pragma unroll
                for (int n = 0; n < 2; ++n) pre[m][bj][n] = *(const f32x4*)(base + off + bj * HALF + n * 16); }
        const bool bad = st.run(acc, u, wr, wc, fr, fq, lds, wid, lane) || poison != 0u;
        const float qnan = __builtin_nanf("");
#pragma unroll
        for (int ai = 0; ai < 2; ++ai)
#pragma unroll
            for (int m = 0; m < 4; ++m) { const int r = ai * HALF + wr * 64 + m * 16 + fr; const f32x2v sr = S[r]; const size_t off = (size_t)(u.pm * BM + r) * ldc + col0;
#pragma unroll
                for (int bj = 0; bj < 2; ++bj)
#pragma unroll
                    for (int n = 0; n < 2; ++n) { const f32x4 bs = ai == 0 ? pre[m][bj][n] : *(const f32x4*)(base + off + bj * HALF + n * 16); f32x4 o = bs + (acc[ai][bj][m][n] - sr.x) * sr.y;
                        if (bad) o = (f32x4){qnan, qnan, qnan, qnan}; *(f32x4*)(out + off + bj * HALF + n * 16) = o; }
                if (m & 1) asm volatile("" ::: "memory"); }
    }
};
struct EpiLnResLn {
    static constexpr bool PERM = false, AFTER_DRAIN = true;
    const float* base; float* out; bf16_t* xn; int ldc; const float* bias; PanelStats st1, st2; unsigned poison;
    __device__ __forceinline__ void fused(f32x4 (&acc)[2][2][4][2], const Unit& u, int wr, int wc, int fr, int fq, PG8_LAS unsigned char* lds, int wid, int lane) const {
        typedef float f32x2v __attribute__((ext_vector_type(2))); typedef unsigned u32x2v __attribute__((ext_vector_type(2)));
        const PG8_LAS f32x2v* S = (const PG8_LAS f32x2v*)(lds + 8192);
        const int col0 = u.pn * BM + wc * 32 + 4 * fq;
#pragma unroll
        for (int bj = 0; bj < 2; ++bj)
#pragma unroll
            for (int n = 0; n < 2; ++n) { const f32x4 bv = bias ? *(const f32x4*)(bias + col0 + bj * HALF + n * 16) : (f32x4){0.f, 0.f, 0.f, 0.f};
#pragma unroll
                for (int ai = 0; ai < 2; ++ai)
#pragma unroll
                    for (int m = 0; m < 4; ++m) acc[ai][bj][m][n] += bv; }
        bool bad = st1.run(acc, u, wr, wc, fr, fq, lds, wid, lane) || poison != 0u;
        const float qnan = __builtin_nanf("");
#pragma unroll
        for (int ai = 0; ai < 2; ++ai)
#pragma unroll
            for (int m = 0; m < 4; ++m) { const int r = ai * HALF + wr * 64 + m * 16 + fr; const f32x2v sr = S[r]; const size_t off = (size_t)(u.pm * BM + r) * ldc + col0;
#pragma unroll
                for (int bj = 0; bj < 2; ++bj)
#pragma unroll
                    for (int n = 0; n < 2; ++n) { const f32x4 bs = *(const f32x4*)(base + off + bj * HALF + n * 16); acc[ai][bj][m][n] = bs + (acc[ai][bj][m][n] - sr.x) * sr.y; }
                asm volatile("" : "+v"(acc[ai][0][m][0]), "+v"(acc[ai][0][m][1]), "+v"(acc[ai][1][m][0]), "+v"(acc[ai][1][m][1]));
                if (m & 1) asm volatile("" ::: "memory"); }
        const bool bad1 = bad;
        bad = st2.run(acc, u, wr, wc, fr, fq, lds, wid, lane) || bad;
#pragma unroll
        for (int ai = 0; ai < 2; ++ai)
#pragma unroll
            for (int m = 0; m < 4; ++m) { const int r = ai * HALF + wr * 64 + m * 16 + fr; const f32x2v sr = S[r]; const size_t off = (size_t)(u.pm * BM + r) * ldc + col0;
#pragma unroll
                for (int bj = 0; bj < 2; ++bj)
#pragma unroll
                    for (int n = 0; n < 2; ++n) { const f32x4 x1 = acc[ai][bj][m][n]; *(f32x4*)(out + off + bj * HALF + n * 16) = bad1 ? (f32x4){qnan, qnan, qnan, qnan} : x1;
                        const f32x4 o = (x1 - sr.x) * sr.y; u32x2v w; w.x = cvt_pk_bf16(o[0], o[1]); w.y = cvt_pk_bf16(o[2], o[3]);
                        if (bad) { w.x = 0x7fc07fc0u; w.y = 0x7fc07fc0u; } *(u32x2v*)(xn + off + bj * HALF + n * 16) = w; }
                asm volatile("" ::: "memory"); }
    }
};

template <class Epi, class Sched, bool ALIGN_EPI = false, bool SP2 = false>
__device__ __forceinline__ void gemm_phase(PG8_LAS unsigned char* lds, const Gemm g, const Sched& S, const Epi& E) {
    int tid_ = threadIdx.x; asm volatile("" : "+v"(tid_));
    const int tid = tid_, wid = __builtin_amdgcn_readfirstlane(tid >> 6), lane = tid & 63, wr = wid >> 2, wc = wid & 3, fr = lane & 15, fq = lane >> 4;
    const int K = g.K, nt = K / BK;
    unsigned voffA[2], voffB[2];
#pragma unroll
    for (int i = 0; i < 2; ++i) { int R, C; stage_rc(tid * 16 + i * 8192, R, C); const int Rb = Epi::PERM ? ((R & ~31) + perm32(R & 31)) : R;
        voffA[i] = (unsigned)(R * K + C) * 2u; voffB[i] = (unsigned)(Rb * K + C) * 2u; }
    const size_t kstep = (size_t)(BK * 2);
    const size_t hstep = (size_t)HALF * K * 2;
    const size_t tstep = 2 * hstep;
    const unsigned ldsw = (unsigned)wid * 1024u;
    const int aoff = lds_byte(wr * 64 + fr, fq * 8), boff = lds_byte(wc * 32 + fr, fq * 8);
#define PG8_SA(b, h) (((b) * 2 + (h)) * HTB)
#define PG8_SB(b, h) ((4 + (b) * 2 + (h)) * HTB)
#define PG8_STAGE(bufoff, gbase, voff) do { _Pragma("unroll") for (int _i = 0; _i < 2; ++_i) \
        __builtin_amdgcn_global_load_lds((const unsigned*)((const char*)(gbase) + (voff)[_i]), (PG8_LAS unsigned*)(lds + (bufoff) + ldsw + _i * 8192), 16, 0, 0); } while (0)
#define PG8_LDA(dst, b, h) do { _Pragma("unroll") for (int m = 0; m < 4; ++m) _Pragma("unroll") for (int k = 0; k < 2; ++k) dst[m][k] = *(const PG8_LAS bf16x8*)(lds + PG8_SA(b, h) + aoff + m * 2048 + k * 1024); } while (0)
#define PG8_LDB(dst, b, h) do { _Pragma("unroll") for (int n = 0; n < 2; ++n) _Pragma("unroll") for (int k = 0; k < 2; ++k) dst[n][k] = *(const PG8_LAS bf16x8*)(lds + PG8_SB(b, h) + boff + n * 2048 + k * 1024); } while (0)
#define PG8_MMA(ai, bj, At, Bt) do { __builtin_amdgcn_s_setprio(1); _Pragma("unroll") for (int m = 0; m < 4; ++m) _Pragma("unroll") for (int n = 0; n < 2; ++n) _Pragma("unroll") for (int k = 0; k < 2; ++k) \
        acc[ai][bj][m][n] = __builtin_amdgcn_mfma_f32_16x16x32_bf16(Bt[n][k], At[m][k], acc[ai][bj][m][n], 0, 0, 0); __builtin_amdgcn_s_setprio(0); } while (0)
#define PG8_WAIT_V(n) asm volatile("s_waitcnt vmcnt(" #n ")" ::: "memory")
#define PG8_WAIT_L(n) asm volatile("s_waitcnt lgkmcnt(" #n ")" ::: "memory")
#define PG8_BAR __builtin_amdgcn_s_barrier()
#define PG8_SCHED __builtin_amdgcn_sched_barrier(0)
    Unit cur, nxt; int ui = 0;
    if (!S.next(0, cur)) return;
    f32x4 acc[2][2][4][2];
#pragma unroll
    for (int a = 0; a < 2; ++a)
#pragma unroll
        for (int b = 0; b < 2; ++b)
#pragma unroll
            for (int m = 0; m < 4; ++m)
#pragma unroll
                for (int n = 0; n < 2; ++n) acc[a][b][m][n] = (f32x4){0.f, 0.f, 0.f, 0.f};
    bf16x8 At[4][2], B0[2][2], B1[2][2];
    const char* cA = (const char*)g.A + (size_t)cur.pm * tstep; const char* cB = (const char*)g.Bt + (size_t)cur.pn * tstep;
    S.a_ready(cur);
    if constexpr (SP2) {
        PG8_STAGE(PG8_SB(0, 0), cB, voffB); PG8_STAGE(PG8_SB(0, 1), cB + hstep, voffB); PG8_STAGE(PG8_SA(0, 0), cA, voffA); PG8_STAGE(PG8_SA(0, 1), cA + hstep, voffA);
        if (wr == 1) PG8_BAR;
        PG8_WAIT_V(2); PG8_BAR;
        PG8_STAGE(PG8_SB(1, 0), cB + kstep, voffB); PG8_STAGE(PG8_SA(1, 0), cA + kstep, voffA); PG8_STAGE(PG8_SB(1, 1), cB + hstep + kstep, voffB);
        PG8_WAIT_V(6); PG8_BAR;
    } else {
        PG8_STAGE(PG8_SB(0, 0), cB, voffB); PG8_STAGE(PG8_SA(0, 0), cA, voffA); PG8_STAGE(PG8_SB(0, 1), cB + hstep, voffB); PG8_STAGE(PG8_SA(0, 1), cA + hstep, voffA);
        if (wr == 1) PG8_BAR;
        PG8_WAIT_V(4); PG8_BAR;
        PG8_STAGE(PG8_SB(1, 0), cB + kstep, voffB); PG8_STAGE(PG8_SA(1, 0), cA + kstep, voffA); PG8_STAGE(PG8_SB(1, 1), cB + hstep + kstep, voffB);
        PG8_WAIT_V(6); PG8_BAR;
    }
    for (;;) {
        const bool has_next = S.next(ui + 1, nxt);
        const char* nA = has_next ? (const char*)g.A + (size_t)nxt.pm * tstep : cA; const char* nB = has_next ? (const char*)g.Bt + (size_t)nxt.pn * tstep : cB;
        for (int t = 0; t < nt; t += 2) {
            const bool last = (t == nt - 2);
            const char* a1 = cA + (size_t)(t + 1) * kstep;
            const char* a2 = last ? nA : cA + (size_t)(t + 2) * kstep; const char* b2 = last ? nB : cB + (size_t)(t + 2) * kstep;
            const char* a3 = a2 + kstep; const char* b3 = b2 + kstep;
            if (last && has_next) S.a_ready(nxt);
            if constexpr (SP2) {
            PG8_LDB(B0, 0, 0); PG8_LDB(B1, 0, 1); PG8_SCHED; PG8_LDA(At, 0, 0); PG8_STAGE(PG8_SA(1, 1), a1 + hstep, voffA);
            PG8_WAIT_V(8); PG8_WAIT_L(0); PG8_BAR; PG8_MMA(0, 0, At, B0); PG8_MMA(0, 1, At, B1); PG8_BAR; PG8_SCHED;
            PG8_LDA(At, 0, 1); PG8_STAGE(PG8_SB(0, 0), b2, voffB); PG8_STAGE(PG8_SB(0, 1), b2 + hstep, voffB); PG8_STAGE(PG8_SA(0, 0), a2, voffA);
            PG8_WAIT_V(8); PG8_WAIT_L(0); PG8_BAR; PG8_MMA(1, 0, At, B0); PG8_MMA(1, 1, At, B1); PG8_BAR; PG8_SCHED;
            PG8_LDB(B0, 1, 0); PG8_LDB(B1, 1, 1); PG8_SCHED; PG8_LDA(At, 1, 0); PG8_STAGE(PG8_SA(0, 1), a2 + hstep, voffA);
            PG8_WAIT_V(8); PG8_WAIT_L(0); PG8_BAR; PG8_MMA(0, 0, At, B0); PG8_MMA(0, 1, At, B1); PG8_BAR; PG8_SCHED;
            PG8_LDA(At, 1, 1); PG8_STAGE(PG8_SB(1, 0), b3, voffB); PG8_STAGE(PG8_SB(1, 1), b3 + hstep, voffB); PG8_STAGE(PG8_SA(1, 0), a3, voffA);
            PG8_WAIT_V(8); PG8_WAIT_L(0); PG8_BAR; PG8_MMA(1, 0, At, B0); PG8_MMA(1, 1, At, B1); PG8_BAR; PG8_SCHED;
            } else {
            PG8_LDB(B0, 0, 0); PG8_SCHED; PG8_LDA(At, 0, 0); PG8_STAGE(PG8_SA(1, 1), a1 + hstep, voffA);
            PG8_WAIT_L(8); PG8_BAR; PG8_WAIT_L(0); PG8_MMA(0, 0, At, B0); PG8_BAR; PG8_SCHED;
            PG8_LDB(B1, 0, 1); PG8_STAGE(PG8_SB(0, 0), b2, voffB);
            PG8_BAR; PG8_WAIT_L(0); PG8_MMA(0, 1, At, B1); PG8_BAR;
            PG8_LDA(At, 0, 1); PG8_STAGE(PG8_SA(0, 0), a2, voffA);
            PG8_BAR; PG8_WAIT_L(0); PG8_MMA(1, 0, At, B0); PG8_BAR; PG8_SCHED;
            PG8_STAGE(PG8_SB(0, 1), b2 + hstep, voffB);
            PG8_WAIT_V(6); PG8_BAR; PG8_MMA(1, 1, At, B1); PG8_BAR;
            PG8_LDB(B0, 1, 0); PG8_SCHED; PG8_LDA(At, 1, 0); PG8_STAGE(PG8_SA(0, 1), a2 + hstep, voffA);
            PG8_WAIT_L(8); PG8_BAR; PG8_WAIT_L(0); PG8_MMA(0, 0, At, B0); PG8_BAR; PG8_SCHED;
            PG8_LDB(B1, 1, 1); PG8_STAGE(PG8_SB(1, 0), b3, voffB);
            PG8_BAR; PG8_WAIT_L(0); PG8_MMA(0, 1, At, B1); PG8_BAR;
            PG8_LDA(At, 1, 1); PG8_STAGE(PG8_SA(1, 0), a3, voffA);
            PG8_BAR; PG8_WAIT_L(0); PG8_MMA(1, 0, At, B0); PG8_BAR; PG8_SCHED;
            PG8_STAGE(PG8_SB(1, 1), b3 + hstep, voffB);
            PG8_WAIT_V(6); PG8_BAR; PG8_MMA(1, 1, At, B1); PG8_BAR;
            }
        }
        if constexpr (ALIGN_EPI) { if (wr == 0) PG8_BAR; }
        if constexpr (!Epi::AFTER_DRAIN) { E(acc, cur, wr, wc, fr, fq); S.done(cur); }
        if (!has_next) break;
#pragma unroll
        for (int a = 0; a < 2; ++a)
#pragma unroll
            for (int b = 0; b < 2; ++b)
#pragma unroll
                for (int m = 0; m < 4; ++m)
#pragma unroll
                    for (int n = 0; n < 2; ++n) acc[a][b][m][n] = (f32x4){0.f, 0.f, 0.f, 0.f};
        cur = nxt; cA = nA; cB = nB; ++ui;
        if constexpr (ALIGN_EPI) { if (wr == 1) PG8_BAR; }
    }
    PG8_WAIT_V(0);
    if constexpr (!ALIGN_EPI) { if (wr == 0) PG8_BAR; }
    PG8_BAR;
    if constexpr (Epi::AFTER_DRAIN) { E.fused(acc, cur, wr, wc, fr, fq, lds, wid, lane); S.done(cur); }
#undef PG8_SA
#undef PG8_SB
#undef PG8_STAGE
#undef PG8_LDA
#undef PG8_LDB
#undef PG8_MMA
#undef PG8_WAIT_V
#undef PG8_WAIT_L
#undef PG8_BAR
#undef PG8_SCHED
}
}
#define GAS __attribute__((address_space(1)))
#define LAS __attribute__((address_space(3)))
typedef unsigned short bf16;
typedef unsigned v4u __attribute__((ext_vector_type(4)));
typedef float f32x4 __attribute__((ext_vector_type(4)));
typedef short bf16x8 __attribute__((ext_vector_type(8)));
typedef GAS unsigned gu32;
typedef GAS unsigned long long gu64;
#define RLX_AGENT __ATOMIC_RELAXED, __HIP_MEMORY_SCOPE_AGENT
#define LDS_WAIT() asm volatile("s_waitcnt lgkmcnt(0)" ::: "memory")
#define VM_WAIT() asm volatile("s_waitcnt vmcnt(0)" ::: "memory")
__device__ __forceinline__ unsigned long long rt() { return __builtin_amdgcn_s_memrealtime(); }
__device__ __forceinline__ unsigned f2bf(float f) { unsigned u = __builtin_bit_cast(unsigned, f); return (u + 0x7fffu + ((u >> 16) & 1u)) >> 16; }
__device__ __forceinline__ unsigned pk2(float lo, float hi) { return f2bf(lo) | (f2bf(hi) << 16); }

#define XB_TMO      128
#define XB_XCNT(j)  (256  + 64 * (j))
#define XB_XSUB(j)  (1280 + 64 * (j))
#define XB_XGEN(j)  (2304 + 64 * (j))
#define XB_TOP      3328
#define XB_TOPGEN   3392
#define XCD_BAR_WORDS 3456
#define XB_SPIN_CAP (1u << 18)

__device__ __forceinline__ unsigned xb_ld(unsigned* p)              { return __hip_atomic_load(p, __ATOMIC_RELAXED, __HIP_MEMORY_SCOPE_AGENT); }
__device__ __forceinline__ unsigned xb_add(unsigned* p, unsigned v) { return __hip_atomic_fetch_add(p, v, __ATOMIC_RELAXED, __HIP_MEMORY_SCOPE_AGENT); }
__device__ __forceinline__ unsigned xb_xcc_id() { return (unsigned)__builtin_amdgcn_s_getreg((3 << 11) | 20) & 0xFu; }
#define XB_SPIN(cond, bar) do { unsigned _sp = 0; while (cond) { __builtin_amdgcn_s_sleep(1); \
    if ((++_sp & 255u) == 0u) { if (xb_ld(&(bar)[XB_TMO])) break; if (_sp > XB_SPIN_CAP) { atomicAdd(&(bar)[XB_TMO], 1u); break; } } } } while (0)

struct XcdBarrier {
    unsigned* bar; unsigned x;
    volatile LAS unsigned* st;
};

__device__ __forceinline__ XcdBarrier xcd_barrier_post(unsigned* bar, volatile LAS unsigned* st) {
    XcdBarrier b; b.bar = bar; b.x = xb_xcc_id(); b.st = st;
    if (threadIdx.x == 0) (void)xb_add(&bar[XB_XCNT(b.x)], 1u);
    return b;
}
__device__ __forceinline__ void xcd_barrier_complete(unsigned* bar, unsigned x, unsigned& nloc, unsigned& nx) {
    const unsigned G = gridDim.x * gridDim.y * gridDim.z;
    unsigned sum, cnt, mine, sp = 0u;
    for (;;) {
        sum = 0u; cnt = 0u; mine = 0u;
#pragma unroll
        for (unsigned j = 0; j < 16; ++j) { const unsigned c = xb_ld(&bar[XB_XCNT(j)]); sum += c; cnt += (c > 0u) ? 1u : 0u; mine = (j == x) ? c : mine; }
        if (sum == G) break;
        __builtin_amdgcn_s_sleep(1);
        if ((++sp & 255u) == 0u) { if (xb_ld(&bar[XB_TMO])) break; if (sp > XB_SPIN_CAP) { atomicAdd(&bar[XB_TMO], 1u); break; } }
    }
    nloc = mine > 0u ? mine : 1u; nx = cnt > 0u ? cnt : 1u;
}

__device__ __forceinline__ void xcd_barrier(const XcdBarrier& b) {
    asm volatile("s_waitcnt vmcnt(0)" ::: "memory");
    __syncthreads();
    if (threadIdx.x == 0) {
        unsigned* bar = b.bar;
        __builtin_amdgcn_s_waitcnt(0);
        unsigned nloc = b.st[0], nx = b.st[1];
        if (nloc == 0u) { xcd_barrier_complete(bar, b.x, nloc, nx); b.st[0] = nloc; b.st[1] = nx; }
        const unsigned old = xb_add(&bar[XB_XSUB(b.x)], 1u);
        const unsigned gen = old / nloc;
        if (old + 1u == (gen + 1u) * nloc) {
            __builtin_amdgcn_fence(__ATOMIC_RELEASE, "agent");
            asm volatile("s_waitcnt vmcnt(0)" ::: "memory");
            const unsigned og = xb_add(&bar[XB_TOP], 1u);
            const unsigned tg = og / nx;
            if (og + 1u == (tg + 1u) * nx) xb_add(&bar[XB_TOPGEN], 1u);
            else XB_SPIN(xb_ld(&bar[XB_TOPGEN]) == tg, bar);
            __builtin_amdgcn_fence(__ATOMIC_ACQUIRE, "agent");
            xb_add(&bar[XB_XGEN(b.x)], 1u);
            asm volatile("s_waitcnt vmcnt(0)" ::: "memory");
        } else {
            XB_SPIN(xb_ld(&bar[XB_XGEN(b.x)]) == gen, bar);
            __builtin_amdgcn_fence(__ATOMIC_ACQUIRE, "agent");
            asm volatile("s_waitcnt vmcnt(0)" ::: "memory");
        }
    }
    __syncthreads();
}

constexpr int NWAVES = 8;
#ifndef MK_N_LAUNCHES
#define MK_N_LAUNCHES 1
#endif
constexpr int BATCH = 8, SEQ = 2048, D = 1024, M = BATCH * SEQ, DEPTH = 2;
constexpr int IN_COLS = 8208, DFF = 2816, CHUNK = 64, NCH = SEQ / CHUNK;
constexpr int NT_A = 21, NT_B = 12, WIN_ROWS = (NT_A + NT_B) * 256;
constexpr float EPS = 1e-6f;
constexpr int PH_PER_LAYER = 9;
constexpr int PER_PHASE = 1 + PH_PER_LAYER * DEPTH;
constexpr int N_LAUNCHES = MK_N_LAUNCHES;

constexpr size_t MiB = 1u << 20;
constexpr size_t WS_CTL = 0, CTL_ZERO_BYTES = 1 * MiB;
constexpr size_t WS_GA = 1 * MiB;
constexpr size_t WS_WIN = 2 * MiB;
constexpr size_t WS_WABC = WS_WIN + (size_t)WIN_ROWS * 1024 * 2;
constexpr size_t WS_WOUT = WS_WABC + 3 * MiB;
constexpr size_t WS_WGU = WS_WOUT + 2 * MiB;
constexpr size_t WS_WDN = WS_WGU + 11 * MiB;
static_assert(WS_WDN + (size_t)1024 * 2816 * 2 <= 40 * MiB, "weights fit [2,40) MiB");
constexpr size_t WS_ROPE = 40 * MiB;
constexpr size_t WS_H = 48 * MiB;
constexpr size_t WS_Z = 80 * MiB, WS_RQ = 96 * MiB, WS_RK = 112 * MiB, WS_RV = 128 * MiB, WS_GQ = 144 * MiB, WS_GK = 152 * MiB, WS_GV = 160 * MiB;
constexpr size_t WS_Y = 176 * MiB;
constexpr size_t WS_GATES = 80 * MiB;
constexpr size_t WS_MO = 80 * MiB;
constexpr size_t WS_H2 = 224 * MiB;
constexpr size_t WS_ACT = 80 * MiB;
constexpr size_t WS_F = 168 * MiB;
constexpr size_t WS_END = 256 * MiB;
constexpr int CW_TMO = 0, CW_CODE = 1;
constexpr int CW_BAR = 4096;

constexpr int RING_OFF = 0, RING_BYTES = 131072;
constexpr int LDSCTL_OFF = RING_BYTES, MISC_OFF = LDSCTL_OFF + 320;
constexpr int LDS_BYTES = 147456;

typedef float f32x16 __attribute__((ext_vector_type(16)));
typedef unsigned u32x2 __attribute__((ext_vector_type(2)));
#define MFMA32(a, b, c) __builtin_amdgcn_mfma_f32_32x32x16_bf16((a), (b), (c), 0, 0, 0)
#define LBAR() do { asm volatile("s_waitcnt lgkmcnt(0)" ::: "memory"); __builtin_amdgcn_s_barrier(); asm volatile("" ::: "memory"); } while (0)
__device__ __forceinline__ float bf2f(unsigned b) { return __uint_as_float(b << 16); }
__device__ __forceinline__ float bflo(unsigned w) { return __uint_as_float(w << 16); }
__device__ __forceinline__ float bfhi(unsigned w) { return __uint_as_float(w & 0xffff0000u); }
__device__ __forceinline__ float sigmoidf_(float x) { return __builtin_amdgcn_rcpf(1.0f + __builtin_amdgcn_exp2f(-1.44269504089f * x)); }
__device__ __forceinline__ float siluf_(float x) { return x * sigmoidf_(x); }
__device__ __forceinline__ unsigned char* opaque(unsigned char* p) { asm volatile("" : "+s"(p)); return p; }
__device__ __forceinline__ int crow(int reg, int h) { return (reg & 3) + 8 * (reg >> 2) + 4 * h; }

struct Frame {
    LAS unsigned char* lds;
    volatile LAS unsigned* MISC;
    gu32* ctl;
    unsigned char* ws;
    int tid, lane, wave;
    int vcu, G;
};
struct Args { const float* in[19]; float* out; unsigned char* ws; int ph_lo, ph_hi, li, pad; };
enum { I_X = 0, I_POS = 1, I_NMIXPRE = 2, I_WIN = 3, I_CONVW = 4, I_RETGN = 5, I_WA2 = 6, I_BA = 7, I_GLAGN = 8, I_WBA = 9, I_WBB = 10, I_WBC = 11, I_WOUT = 12,
       I_NMIXPOST = 13, I_NFFNPRE = 14, I_WFG = 15, I_WFU = 16, I_WFD = 17, I_NFFNPOST = 18 };

__device__ __forceinline__ float wave_sum(float v) {
#pragma unroll
    for (int o = 1; o < 64; o <<= 1) v += __shfl_xor(v, o);
    return v;
}

__device__ __forceinline__ void cvt_item(const float* W, int ldw, int nvalid, bf16* dst, int K, LAS float* scr, int lane) {
#pragma unroll 8
    for (int i = 0; i < 32; ++i) { const int kk = 2 * i + (lane >> 5), nn = lane & 31; float v = 0.f; if (nn < nvalid) v = W[(size_t)kk * ldw + nn]; scr[kk * 33 + nn] = v; }
    LDS_WAIT(); asm volatile("" ::: "memory");
    const int c = lane & 7;
#pragma unroll
    for (int j = 0; j < 4; ++j) { const int n = (lane >> 3) + 8 * j; const LAS float* s = scr + (8 * c) * 33 + n;
        v4u o; o.x = pk2(s[0 * 33], s[1 * 33]); o.y = pk2(s[2 * 33], s[3 * 33]); o.z = pk2(s[4 * 33], s[5 * 33]); o.w = pk2(s[6 * 33], s[7 * 33]);
        *(GAS v4u*)(dst + (size_t)n * K + 8 * c) = o; }
    LDS_WAIT(); asm volatile("" ::: "memory");
}
__device__ __forceinline__ int win_src(int r0, int& nvalid) {
    const int t = r0 >> 8, rin = r0 & 255; nvalid = 32;
    if (t < 4) return ((rin >> 7) ? 1024 : 0) + 128 * t + (rin & 127);
    if (t < 6) return 512 + (r0 - 1024);
    if (t < 10) { const int base = (t < 8) ? 1536 : 2048, T = (t < 8) ? t - 6 : t - 8;
        return base + (2 * T + ((rin >> 6) & 1)) * 128 + (rin >> 7) * 64 + (rin & 63); }
    if (t < 20) return r0;
    if (t == 20) { nvalid = (rin == 0) ? 16 : 0; return 5120; }
    return 5136 + (r0 - 5376);
}
__device__ __forceinline__ void convert_layer(Frame& F, const Args& a, int layer) {
    LAS float* scr = (LAS float*)(F.lds + RING_OFF + F.wave * 16384);
    const int gw = F.vcu * NWAVES + F.wave, NGW = F.G * NWAVES;
    constexpr int I_WIN_ = (WIN_ROWS / 32) * 16, I_ABC = 96 * 8, I_OUT = 32 * 16, I_GU = 176 * 16, I_DN = 32 * 44;
    constexpr int NITEMS = I_WIN_ + I_ABC + I_OUT + I_GU + I_DN;
    bf16* WIN = (bf16*)(F.ws + WS_WIN); bf16* WABC = (bf16*)(F.ws + WS_WABC); bf16* WOUT = (bf16*)(F.ws + WS_WOUT); bf16* WGU = (bf16*)(F.ws + WS_WGU); bf16* WDN = (bf16*)(F.ws + WS_WDN);
    for (int it = gw; it < NITEMS; it += NGW) {
        int r = it;
        if (r < I_WIN_) { const int g = r >> 4, kb = r & 15, r0 = 32 * g; int nv; const int src = win_src(r0, nv);
            cvt_item(a.in[I_WIN] + (size_t)layer * 1024 * IN_COLS + (size_t)(64 * kb) * IN_COLS + src, IN_COLS, nv, WIN + (size_t)r0 * 1024 + 64 * kb, 1024, scr, F.lane); continue; }
        r -= I_WIN_;
        if (r < I_ABC) { const int g = r >> 3, kb = r & 7, r0 = 32 * g, br = r0 >> 10, n = r0 & 1023;
            const float* W = (br == 0 ? a.in[I_WBA] : br == 1 ? a.in[I_WBB] : a.in[I_WBC]) + (size_t)layer * 512 * 1024 + (size_t)(64 * kb) * 1024 + n;
            cvt_item(W, 1024, 32, WABC + (size_t)r0 * 512 + 64 * kb, 512, scr, F.lane); continue; }
        r -= I_ABC;
        if (r < I_OUT) { const int g = r >> 4, kb = r & 15;
            cvt_item(a.in[I_WOUT] + (size_t)layer * 1024 * 1024 + (size_t)(64 * kb) * 1024 + 32 * g, 1024, 32, WOUT + (size_t)(32 * g) * 1024 + 64 * kb, 1024, scr, F.lane); continue; }
        r -= I_OUT;
        if (r < I_GU) { const int g = r >> 4, kb = r & 15, r0 = 32 * g, t = r0 >> 8, rin = r0 & 255;
            const float* W = ((rin >> 7) ? a.in[I_WFU] : a.in[I_WFG]) + (size_t)layer * 1024 * DFF + (size_t)(64 * kb) * DFF + 128 * t + (rin & 127);
            cvt_item(W, DFF, 32, WGU + (size_t)r0 * 1024 + 64 * kb, 1024, scr, F.lane); continue; }
        r -= I_GU;
        { const int g = r / 44, kb = r % 44;
            cvt_item(a.in[I_WFD] + (size_t)layer * DFF * 1024 + (size_t)(64 * kb) * 1024 + 32 * g, 1024, 32, WDN + (size_t)(32 * g) * DFF + 64 * kb, DFF, scr, F.lane); }
    }
}
__device__ __forceinline__ void rope_tables(Frame& F, const Args& a) {
    float* cosT = (float*)(F.ws + WS_ROPE); float* sinT = cosT + (size_t)M * 64;
    const int* pos = (const int*)a.in[I_POS];
    const int gt = F.vcu * (NWAVES * 64) + F.tid, NT = F.G * NWAVES * 64;
    for (int idx = gt; idx < M * 64; idx += NT) {
        const int m = idx >> 6, d = idx & 63;
        const double inv = exp2(-(double)d * (13.287712379549449 / 64.0));
        double rev = (double)pos[m] * inv * 0.15915494309189535;
        rev -= floor(rev);
        const float rf = (float)rev;
        cosT[idx] = __builtin_amdgcn_cosf(rf); sinT[idx] = __builtin_amdgcn_sinf(rf);
    }
}
__device__ __forceinline__ void norm_to_bf16(const f32x4 (&v)[4], float rs, const float* w, bf16* orow, int lane) {
    GAS unsigned long long* o8 = (GAS unsigned long long*)orow + lane;
#pragma unroll
    for (int j = 0; j < 4; ++j) { const f32x4 g = *((const GAS f32x4*)w + lane + 64 * j);
        o8[64 * j] = (unsigned long long)pk2(v[j].x * rs * g.x, v[j].y * rs * g.y) | ((unsigned long long)pk2(v[j].z * rs * g.z, v[j].w * rs * g.w) << 32); }
}
__device__ __forceinline__ float sumsq4(const f32x4 (&v)[4]) { float s = 0.f;
#pragma unroll
    for (int j = 0; j < 4; ++j) s += (v[j].x * v[j].x + v[j].y * v[j].y) + (v[j].z * v[j].z + v[j].w * v[j].w);
    return wave_sum(s); }
__device__ __forceinline__ void rows_norm(Frame& F, const float* x, const float* w, bf16* h) {
    const int gw = F.vcu * NWAVES + F.wave, NGW = F.G * NWAVES;
    for (int m = gw; m < M; m += NGW) {
        f32x4 v[4];
#pragma unroll
        for (int j = 0; j < 4; ++j) v[j] = *((const GAS f32x4*)(x + (size_t)m * D) + F.lane + 64 * j);
        const float rs = 1.0f / sqrtf(sumsq4(v) * (1.0f / D) + EPS);
        norm_to_bf16(v, rs, w, h + (size_t)m * D, F.lane);
    }
}
__device__ __forceinline__ void rows_update(Frame& F, const float* xi, const float* dl, const float* wd, float* xo, const float* wh, bf16* h) {
    const int gw = F.vcu * NWAVES + F.wave, NGW = F.G * NWAVES;
    for (int m = gw; m < M; m += NGW) {
        f32x4 v[4], x[4];
#pragma unroll
        for (int j = 0; j < 4; ++j) { v[j] = *((const GAS f32x4*)(dl + (size_t)m * D) + F.lane + 64 * j); x[j] = *((const GAS f32x4*)(xi + (size_t)m * D) + F.lane + 64 * j); }
        const float rs = 1.0f / sqrtf(sumsq4(v) * (1.0f / D) + EPS);
#pragma unroll
        for (int j = 0; j < 4; ++j) { const f32x4 g = *((const GAS f32x4*)wd + F.lane + 64 * j); x[j] = x[j] + (v[j] * rs) * g; *((GAS f32x4*)(xo + (size_t)m * D) + F.lane + 64 * j) = x[j]; }
        if (wh) { const float rs2 = 1.0f / sqrtf(sumsq4(x) * (1.0f / D) + EPS); norm_to_bf16(x, rs2, wh, h + (size_t)m * D, F.lane); }
    }
}

__device__ __forceinline__ v4u pack8(const f32x4& a, const f32x4& b) { v4u w; w.x = pg8::cvt_pk_bf16(a[0], a[1]); w.y = pg8::cvt_pk_bf16(a[2], a[3]); w.z = pg8::cvt_pk_bf16(b[0], b[1]); w.w = pg8::cvt_pk_bf16(b[2], b[3]); return w; }
__device__ __forceinline__ f32x4 map4(const f32x4& v, int fk) {
    f32x4 o = v;
    if (fk == 1) { o[0] = siluf_(v[0]); o[1] = siluf_(v[1]); o[2] = siluf_(v[2]); o[3] = siluf_(v[3]); }
    else if (fk == 2) { o = v * 0.125f; }
    else if (fk == 3) { o[0] = sigmoidf_(v[0]); o[1] = sigmoidf_(v[1]); o[2] = sigmoidf_(v[2]); o[3] = sigmoidf_(v[3]); }
    return o;
}
template <int MODE> struct EpiProj {
    static constexpr bool PERM = true, AFTER_DRAIN = false;
    unsigned char* ws; int tile0;
    __device__ __forceinline__ void operator()(const pg8::f32x4 (&acc)[2][2][4][2], const pg8::Unit& u, int wr, int wc, int fr, int fq) const {
        const int row0 = u.pm * 256 + wr * 64 + fr, cl = wc * 32 + 8 * fq;
        if (MODE == 1) {
            bf16* dst = (bf16*)(ws + WS_ACT) + u.pn * 128 + cl;
#pragma unroll
            for (int ai = 0; ai < 2; ++ai)
#pragma unroll
                for (int m = 0; m < 4; ++m) { const int row = row0 + ai * 128 + m * 16;
                    const f32x4 a0 = acc[ai][0][m][0], a1 = acc[ai][0][m][1], b0 = acc[ai][1][m][0], b1 = acc[ai][1][m][1];
                    *(GAS v4u*)(dst + (size_t)row * DFF) = pack8(map4(a0, 1) * b0, map4(a1, 1) * b1); }
            return;
        }
        const int t = tile0 + u.pn;
        if (t < 4) {
            bf16* dst = (bf16*)(ws + WS_Z) + t * 128 + cl;
#pragma unroll
            for (int ai = 0; ai < 2; ++ai)
#pragma unroll
                for (int m = 0; m < 4; ++m) { const int row = row0 + ai * 128 + m * 16;
                    *(GAS v4u*)(dst + (size_t)row * 512) = pack8(acc[ai][0][m][0] * acc[ai][1][m][0], acc[ai][0][m][1] * acc[ai][1][m][1]); }
            return;
        }
        if (t >= 6 && t < 10) {
            const bool isq = t < 8; const float sc = isq ? 0.08838834764831845f : 1.0f;
            const int head = 2 * (isq ? t - 6 : t - 8) + (wc >> 1), d0 = (wc & 1) * 32 + 8 * fq;
            bf16* dst = (bf16*)(ws + (isq ? WS_RQ : WS_RK)) + head * 128 + d0;
            const float* cosT = (const float*)(ws + WS_ROPE); const float* sinT = cosT + (size_t)M * 64;
#pragma unroll
            for (int ai = 0; ai < 2; ++ai)
#pragma unroll
                for (int m = 0; m < 4; ++m) { const int row = row0 + ai * 128 + m * 16;
                    const f32x4 c0 = *(const GAS f32x4*)(cosT + (size_t)row * 64 + d0), c1 = *(const GAS f32x4*)(cosT + (size_t)row * 64 + d0 + 4);
                    const f32x4 s0 = *(const GAS f32x4*)(sinT + (size_t)row * 64 + d0), s1 = *(const GAS f32x4*)(sinT + (size_t)row * 64 + d0 + 4);
                    const f32x4 x10 = acc[ai][0][m][0], x11 = acc[ai][0][m][1], x20 = acc[ai][1][m][0], x21 = acc[ai][1][m][1];
                    *(GAS v4u*)(dst + (size_t)row * 512) = pack8((x10 * c0 - x20 * s0) * sc, (x11 * c1 - x21 * s1) * sc);
                    *(GAS v4u*)(dst + (size_t)row * 512 + 64) = pack8((x20 * c0 + x10 * s0) * sc, (x21 * c1 + x11 * s1) * sc); }
            return;
        }
        if (t == 20) {
            if (wc == 0 && fq < 2) {
                float* dst = (float*)(ws + WS_GA) + 8 * fq;
#pragma unroll
                for (int ai = 0; ai < 2; ++ai)
#pragma unroll
                    for (int m = 0; m < 4; ++m) { const int row = row0 + ai * 128 + m * 16;
                        *(GAS f32x4*)(dst + (size_t)row * 16) = acc[ai][0][m][0]; *(GAS f32x4*)(dst + (size_t)row * 16 + 4) = acc[ai][0][m][1]; }
            }
            return;
        }
        size_t boff; int ld, coff, fk;
        if (t < 6) { boff = WS_Y; ld = 512; coff = (t - 4) * 256; fk = 0; }
        else if (t < 12) { boff = WS_RV; ld = 512; coff = (t - 10) * 256; fk = 0; }
        else if (t < 14) { boff = WS_Y + (size_t)M * 512 * 2; ld = 512; coff = (t - 12) * 256; fk = 1; }
        else if (t == 14) { boff = WS_GQ; ld = 256; coff = 0; fk = 2; }
        else if (t == 15) { boff = WS_GK; ld = 256; coff = 0; fk = 0; }
        else if (t < 18) { boff = WS_GV; ld = 512; coff = (t - 16) * 256; fk = 0; }
        else if (t < 20) { boff = WS_Y + (size_t)M * 512 * 4; ld = 512; coff = (t - 18) * 256; fk = 1; }
        else { const int g = (t - 21) >> 2; boff = WS_GATES + (size_t)g * M * 1024 * 2; ld = 1024; coff = ((t - 21) & 3) * 256; fk = 3; }
        bf16* dst = (bf16*)(ws + boff) + coff + cl;
#pragma unroll
        for (int ai = 0; ai < 2; ++ai)
#pragma unroll
            for (int m = 0; m < 4; ++m) { const int row = row0 + ai * 128 + m * 16;
#pragma unroll
                for (int bj = 0; bj < 2; ++bj)
                    *(GAS v4u*)(dst + (size_t)row * ld + bj * 128) = pack8(map4(acc[ai][bj][m][0], fk), map4(acc[ai][bj][m][1], fk)); }
    }
};
struct EpiMerge {
    static constexpr bool PERM = true, AFTER_DRAIN = false;
    const bf16* gates; bf16* mbuf;
    __device__ __forceinline__ void operator()(const pg8::f32x4 (&acc)[2][2][4][2], const pg8::Unit& u, int wr, int wc, int fr, int fq) const {
        const int br = u.pm >> 6, pm = u.pm & 63, pn = u.pn & 3;
        const int row0 = pm * 256 + wr * 64 + fr, col0 = pn * 256 + wc * 32 + 8 * fq;
        const bf16* gp = gates + (size_t)br * M * 1024;
#pragma unroll
        for (int ai = 0; ai < 2; ++ai)
#pragma unroll
            for (int m = 0; m < 4; ++m) { const int row = row0 + ai * 128 + m * 16;
#pragma unroll
                for (int bj = 0; bj < 2; ++bj) { const size_t off = (size_t)row * 1024 + col0 + bj * 128;
                    const v4u g8 = *(const GAS v4u*)(gp + off);
                    f32x4 r0 = acc[ai][bj][m][0], r1 = acc[ai][bj][m][1];
                    r0[0] *= bflo(g8.x); r0[1] *= bfhi(g8.x); r0[2] *= bflo(g8.y); r0[3] *= bfhi(g8.y); r1[0] *= bflo(g8.z); r1[1] *= bfhi(g8.z); r1[2] *= bflo(g8.w); r1[3] *= bfhi(g8.w);
                    if (br > 0) { const v4u m8 = *(const GAS v4u*)(mbuf + off);
                        r0[0] += bflo(m8.x); r0[1] += bfhi(m8.x); r0[2] += bflo(m8.y); r0[3] += bfhi(m8.y); r1[0] += bflo(m8.z); r1[1] += bfhi(m8.z); r1[2] += bflo(m8.w); r1[3] += bfhi(m8.w); }
                    *(GAS v4u*)(mbuf + off) = pack8(r0, r1); } }
    }
};
struct MergeOrder {
    pg8::StaticOrder base;
    __device__ bool next(int i, pg8::Unit& u) const { pg8::Unit t; if (!base.next(i / 3, t)) return false; const int br = i % 3; u.pm = br * 64 + t.pm; u.pn = br * 4 + t.pn; return true; }
    __device__ __forceinline__ void a_ready(const pg8::Unit&) const {}
    __device__ __forceinline__ void done(const pg8::Unit&) const {}
};
struct EpiF32 {
    static constexpr bool PERM = false, AFTER_DRAIN = false;
    float* C; int ldc;
    __device__ __forceinline__ void operator()(const pg8::f32x4 (&acc)[2][2][4][2], const pg8::Unit& u, int wr, int wc, int fr, int fq) const {
        const int row0 = u.pm * 256 + wr * 64 + fr, col0 = u.pn * 256 + wc * 32 + 4 * fq;
#pragma unroll
        for (int ai = 0; ai < 2; ++ai)
#pragma unroll
            for (int m = 0; m < 4; ++m) { float* rowp = C + (size_t)(row0 + ai * 128 + m * 16) * ldc + col0;
#pragma unroll
                for (int bj = 0; bj < 2; ++bj)
#pragma unroll
                    for (int n = 0; n < 2; ++n) *(GAS f32x4*)(rowp + bj * 128 + n * 16) = acc[ai][bj][m][n]; }
    }
};

__device__ __forceinline__ void conv_rows(Frame& F, const float* cw  , int first_wave, int nwaves) {
    const bf16* Z = (const bf16*)(F.ws + WS_Z); bf16* Y = (bf16*)(F.ws + WS_Y);
    const int c8 = F.lane * 8;
    float w0[8], w1[8], w2[8];
#pragma unroll
    for (int i = 0; i < 8; ++i) { w0[i] = cw[c8 + i]; w1[i] = cw[512 + c8 + i]; w2[i] = cw[1024 + c8 + i]; }
    for (int row = first_wave; row < M; row += nwaves) {
        const int t = row & (SEQ - 1);
        const v4u z0 = *(const GAS v4u*)(Z + (size_t)row * 512 + c8);
        v4u z1 = (v4u){0u, 0u, 0u, 0u}, z2 = (v4u){0u, 0u, 0u, 0u};
        if (t >= 1) z1 = *(const GAS v4u*)(Z + (size_t)(row - 1) * 512 + c8);
        if (t >= 2) z2 = *(const GAS v4u*)(Z + (size_t)(row - 2) * 512 + c8);
        const v4u bb = *(const GAS v4u*)(Y + (size_t)row * 512 + c8);
        float o[8];
        o[0] = bflo(bb.x) * (w0[0] * bflo(z2.x) + w1[0] * bflo(z1.x) + w2[0] * bflo(z0.x));
        o[1] = bfhi(bb.x) * (w0[1] * bfhi(z2.x) + w1[1] * bfhi(z1.x) + w2[1] * bfhi(z0.x));
        o[2] = bflo(bb.y) * (w0[2] * bflo(z2.y) + w1[2] * bflo(z1.y) + w2[2] * bflo(z0.y));
        o[3] = bfhi(bb.y) * (w0[3] * bfhi(z2.y) + w1[3] * bfhi(z1.y) + w2[3] * bfhi(z0.y));
        o[4] = bflo(bb.z) * (w0[4] * bflo(z2.z) + w1[4] * bflo(z1.z) + w2[4] * bflo(z0.z));
        o[5] = bfhi(bb.z) * (w0[5] * bfhi(z2.z) + w1[5] * bfhi(z1.z) + w2[5] * bfhi(z0.z));
        o[6] = bflo(bb.w) * (w0[6] * bflo(z2.w) + w1[6] * bflo(z1.w) + w2[6] * bflo(z0.w));
        o[7] = bfhi(bb.w) * (w0[7] * bfhi(z2.w) + w1[7] * bfhi(z1.w) + w2[7] * bfhi(z0.w));
        v4u ov; ov.x = pk2(o[0], o[1]); ov.y = pk2(o[2], o[3]); ov.z = pk2(o[4], o[5]); ov.w = pk2(o[6], o[7]);
        *(GAS v4u*)(Y + (size_t)row * 512 + c8) = ov;
    }
}

#define FRAG(base, row, pitch, kbyte) (*(const LAS bf16x8*)(lds + (base) + (row) * (pitch) + (kbyte)))
template <bool CENTER> __device__ __forceinline__ void norm_out(LAS unsigned char* lds, int OS, bf16* grow  , const float* gn  , int tid) {
    const int nrow = tid >> 3, seg = tid & 7;
    float o[16];
#pragma unroll
    for (int q = 0; q < 4; ++q) { const f32x4 v = *(const LAS f32x4*)(lds + OS + nrow * 528 + seg * 64 + q * 16); o[4 * q] = v[0]; o[4 * q + 1] = v[1]; o[4 * q + 2] = v[2]; o[4 * q + 3] = v[3]; }
    float mean = 0.f;
    if (CENTER) { float s = 0.f;
#pragma unroll
        for (int i = 0; i < 16; ++i) s += o[i];
        s += __shfl_xor(s, 1); s += __shfl_xor(s, 2); s += __shfl_xor(s, 4); mean = s * (1.0f / 128.0f); }
    float q2 = 0.f;
#pragma unroll
    for (int i = 0; i < 16; ++i) { o[i] -= mean; q2 += o[i] * o[i]; }
    q2 += __shfl_xor(q2, 1); q2 += __shfl_xor(q2, 2); q2 += __shfl_xor(q2, 4);
    const float rs = 1.0f / sqrtf(q2 * (1.0f / 128.0f) + EPS);
    bf16* gp = grow + (size_t)nrow * 512 + seg * 16;
    const v4u g0 = *(const GAS v4u*)gp, g1 = *(const GAS v4u*)(gp + 8);
    const f32x4 n0 = *(const GAS f32x4*)(gn + seg * 16), n1 = *(const GAS f32x4*)(gn + seg * 16 + 4), n2 = *(const GAS f32x4*)(gn + seg * 16 + 8), n3 = *(const GAS f32x4*)(gn + seg * 16 + 12);
    v4u y0, y1;
    y0.x = pk2(o[0] * rs * n0[0] * bflo(g0.x), o[1] * rs * n0[1] * bfhi(g0.x)); y0.y = pk2(o[2] * rs * n0[2] * bflo(g0.y), o[3] * rs * n0[3] * bfhi(g0.y));
    y0.z = pk2(o[4] * rs * n1[0] * bflo(g0.z), o[5] * rs * n1[1] * bfhi(g0.z)); y0.w = pk2(o[6] * rs * n1[2] * bflo(g0.w), o[7] * rs * n1[3] * bfhi(g0.w));
    y1.x = pk2(o[8] * rs * n2[0] * bflo(g1.x), o[9] * rs * n2[1] * bfhi(g1.x)); y1.y = pk2(o[10] * rs * n2[2] * bflo(g1.y), o[11] * rs * n2[3] * bfhi(g1.y));
    y1.z = pk2(o[12] * rs * n3[0] * bflo(g1.z), o[13] * rs * n3[1] * bfhi(g1.z)); y1.w = pk2(o[14] * rs * n3[2] * bflo(g1.w), o[15] * rs * n3[3] * bfhi(g1.w));
    *(GAS v4u*)gp = y0; *(GAS v4u*)(gp + 8) = y1;
}
__device__ __forceinline__ void put_t8(LAS unsigned char* lds, int base, int cs, int row, const v4u& p, float sc, bool scaled) {
    const unsigned w[4] = {p.x, p.y, p.z, p.w};
#pragma unroll
    for (int i = 0; i < 4; ++i) {
        unsigned lo = w[i] & 0xffffu, hi = w[i] >> 16;
        if (scaled) { lo = f2bf(bf2f(lo) * sc); hi = f2bf(bf2f(hi) * sc); }
        *(LAS unsigned short*)(lds + base + (8 * cs + 2 * i) * 144 + row * 2) = (unsigned short)lo;
        *(LAS unsigned short*)(lds + base + (8 * cs + 2 * i + 1) * 144 + row * 2) = (unsigned short)hi;
    }
}
__device__ __forceinline__ void put_state_t(LAS unsigned char* lds, int base, int pitch, int v, int d0, const f32x16& st) {
#pragma unroll
    for (int g = 0; g < 4; ++g) { u32x2 w; w.x = pk2(st[4 * g], st[4 * g + 1]); w.y = pk2(st[4 * g + 2], st[4 * g + 3]); *(LAS u32x2*)(lds + base + v * pitch + (d0 + 8 * g) * 2) = w; }
}

__device__ __forceinline__ void ret_chain(Frame& F, const float* gnw, int b, int h) {
    LAS unsigned char* lds = F.lds + RING_OFF;
    constexpr int QS = 0, KS = 17408, OS = 0, KTS = 34816, VTS = 53248, PS = 71680, STS = 80896, P272 = 272, P144 = 144;
    const int tid = F.tid, lane = F.lane, w = F.wave, r_ = lane & 31, hh_ = lane >> 5;
    const size_t rowbase = (size_t)b * SEQ * 512 + (size_t)h * 128;
    const bf16* RQ = (const bf16*)(F.ws + WS_RQ) + rowbase; const bf16* RK = (const bf16*)(F.ws + WS_RK) + rowbase; const bf16* RV = (const bf16*)(F.ws + WS_RV) + rowbase;
    bf16* YB = (bf16*)(F.ws + WS_Y) + (size_t)M * 512 + rowbase;
    const float gamma = 1.0f - exp2f(-5.0f - (float)h), lg2_ = log2f(gamma), g64 = exp2f(64.0f * lg2_);
    const int lrow = 16 * (w & 3) + (lane & 15), cs0 = 4 * (w >> 2) + (lane >> 4), cs1 = cs0 + 8;
    v4u qr0, qr1, kr0, kr1, vr0, vr1;
    { const size_t o = (size_t)lrow * 512; qr0 = *(const GAS v4u*)(RQ + o + cs0 * 8); qr1 = *(const GAS v4u*)(RQ + o + cs1 * 8); kr0 = *(const GAS v4u*)(RK + o + cs0 * 8); kr1 = *(const GAS v4u*)(RK + o + cs1 * 8);
      vr0 = *(const GAS v4u*)(RV + o + cs0 * 8); vr1 = *(const GAS v4u*)(RV + o + cs1 * 8); }
    f32x16 st0, st1;
#pragma unroll
    for (int i = 0; i < 16; ++i) { st0[i] = 0.f; st1[i] = 0.f; }
    for (int i = tid; i < 34816 / 16; i += NWAVES * 64) *(LAS v4u*)(lds + STS + 16 * i) = (v4u){0u, 0u, 0u, 0u};
    const int ib = w & 1, vb = w >> 1;
    const float kd = exp2f((float)(63 - lrow) * lg2_);
    for (int c = 0; c < NCH; ++c) {
        int r = r_, hh = hh_; float lg2 = lg2_; asm volatile("" : "+v"(r), "+v"(hh), "+v"(lg2));
        *(LAS v4u*)(lds + QS + lrow * P272 + cs0 * 16) = qr0; *(LAS v4u*)(lds + QS + lrow * P272 + cs1 * 16) = qr1;
        *(LAS v4u*)(lds + KS + lrow * P272 + cs0 * 16) = kr0; *(LAS v4u*)(lds + KS + lrow * P272 + cs1 * 16) = kr1;
        put_t8(lds, KTS, cs0, lrow, kr0, kd, true); put_t8(lds, KTS, cs1, lrow, kr1, kd, true);
        put_t8(lds, VTS, cs0, lrow, vr0, 1.f, false); put_t8(lds, VTS, cs1, lrow, vr1, 1.f, false);
        if (c + 1 < NCH) { const size_t o = (size_t)((c + 1) * CHUNK + lrow) * 512;
            qr0 = *(const GAS v4u*)(RQ + o + cs0 * 8); qr1 = *(const GAS v4u*)(RQ + o + cs1 * 8); kr0 = *(const GAS v4u*)(RK + o + cs0 * 8); kr1 = *(const GAS v4u*)(RK + o + cs1 * 8);
            vr0 = *(const GAS v4u*)(RV + o + cs0 * 8); vr1 = *(const GAS v4u*)(RV + o + cs1 * 8); }
        LBAR();
        f32x16 acc;
#pragma unroll
        for (int i = 0; i < 16; ++i) acc[i] = 0.f;
#pragma unroll
        for (int ks = 0; ks < 8; ++ks) acc = MFMA32(FRAG(QS, 32 * ib + r, P272, 32 * ks + 16 * hh), FRAG(STS, 32 * vb + r, P272, 32 * ks + 16 * hh), acc);
#pragma unroll
        for (int i = 0; i < 16; ++i) acc[i] *= exp2f((float)(32 * ib + crow(i, hh) + 1) * lg2);
#pragma unroll
        for (int i = 0; i < 16; ++i) { st0[i] *= g64; st1[i] *= g64; }
#pragma unroll
        for (int ks = 0; ks < 4; ++ks) { const bf16x8 bv = FRAG(VTS, 32 * vb + r, P144, 32 * ks + 16 * hh);
            st0 = MFMA32(FRAG(KTS, 64 * ib + r, P144, 32 * ks + 16 * hh), bv, st0);
            st1 = MFMA32(FRAG(KTS, 64 * ib + 32 + r, P144, 32 * ks + 16 * hh), bv, st1); }
        if (w < 4) { const int sib = w >> 1, sjb = w & 1; f32x16 s;
#pragma unroll
            for (int i = 0; i < 16; ++i) s[i] = 0.f;
#pragma unroll
            for (int ks = 0; ks < 8; ++ks) s = MFMA32(FRAG(QS, 32 * sib + r, P272, 32 * ks + 16 * hh), FRAG(KS, 32 * sjb + r, P272, 32 * ks + 16 * hh), s);
            const int jj = 32 * sjb + r;
#pragma unroll
            for (int i = 0; i < 16; ++i) { const int ii = 32 * sib + crow(i, hh); const float p = (ii >= jj) ? s[i] * exp2f((float)(ii - jj) * lg2) : 0.f;
                *(LAS unsigned short*)(lds + PS + ii * P144 + jj * 2) = (unsigned short)f2bf(p); } }
        LBAR();
#pragma unroll
        for (int ks = 0; ks < 4; ++ks) acc = MFMA32(FRAG(PS, 32 * ib + r, P144, 32 * ks + 16 * hh), FRAG(VTS, 32 * vb + r, P144, 32 * ks + 16 * hh), acc);
        put_state_t(lds, STS, P272, 32 * vb + r, 64 * ib + 4 * hh, st0);
        put_state_t(lds, STS, P272, 32 * vb + r, 64 * ib + 32 + 4 * hh, st1);
#pragma unroll
        for (int i = 0; i < 16; ++i) *(LAS float*)(lds + OS + (32 * ib + crow(i, hh)) * 528 + (32 * vb + r) * 4) = acc[i];
        LBAR();
        norm_out<true>(lds, OS, YB + (size_t)(c * CHUNK) * 512, gnw + h * 128, tid);
        LBAR();
    }
}

__device__ __forceinline__ void gla_chain(Frame& F, const float* wa2  , const float* ba  , const float* gnw, int b, int h) {
    LAS unsigned char* lds = F.lds + RING_OFF;
    constexpr int OS = 0, RQS = 0, RKS = 8192, QS = 16384, KS = 25600, KTS = 34816, VTS = 44032, PS = 62464, STS = 71680, GAS_ = 90112, TOT = 94208, DEC = 96256, P144 = 144;
    const int tid = F.tid, lane = F.lane, w = F.wave, r_ = lane & 31, hh_ = lane >> 5;
    const size_t rb = (size_t)b * SEQ;
    const bf16* GQ = (const bf16*)(F.ws + WS_GQ) + rb * 256 + h * 64; const bf16* GK = (const bf16*)(F.ws + WS_GK) + rb * 256 + h * 64;
    const bf16* GV = (const bf16*)(F.ws + WS_GV) + rb * 512 + h * 128;
    bf16* YC = (bf16*)(F.ws + WS_Y) + (size_t)M * 1024 + rb * 512 + h * 128;
    const float* GA = (const float*)(F.ws + WS_GA) + rb * 16;
    float wa[16];
#pragma unroll
    for (int i = 0; i < 16; ++i) wa[i] = wa2[i * 256 + h * 64 + lane];
    const float bias = ba[h * 64 + lane];
    const int lrow = 16 * (w & 3) + (lane & 15), cs0 = 4 * (w >> 2) + (lane >> 4), cs1 = cs0 + 8;
    const int qrow = tid >> 3, qcs = tid & 7;
    v4u qr, kr, vr0, vr1, gr = (v4u){0u, 0u, 0u, 0u};
    { qr = *(const GAS v4u*)(GQ + (size_t)qrow * 256 + qcs * 8); kr = *(const GAS v4u*)(GK + (size_t)qrow * 256 + qcs * 8);
      vr0 = *(const GAS v4u*)(GV + (size_t)lrow * 512 + cs0 * 8); vr1 = *(const GAS v4u*)(GV + (size_t)lrow * 512 + cs1 * 8);
      if (tid < 256) gr = *(const GAS v4u*)(GA + (size_t)tid * 4); }
    f32x16 st;
#pragma unroll
    for (int i = 0; i < 16; ++i) st[i] = 0.f;
    for (int i = tid; i < 18432 / 16; i += NWAVES * 64) *(LAS v4u*)(lds + STS + 16 * i) = (v4u){0u, 0u, 0u, 0u};
    const int ib = w & 1, vb = w >> 1;
    for (int c = 0; c < NCH; ++c) {
        int r = r_, hh = hh_; asm volatile("" : "+v"(r), "+v"(hh));
        *(LAS v4u*)(lds + RQS + qrow * 128 + qcs * 16) = qr; *(LAS v4u*)(lds + RKS + qrow * 128 + qcs * 16) = kr;
        put_t8(lds, VTS, cs0, lrow, vr0, 1.f, false); put_t8(lds, VTS, cs1, lrow, vr1, 1.f, false);
        if (tid < 256) *(LAS v4u*)(lds + GAS_ + tid * 16) = gr;
        if (c + 1 < NCH) { const size_t o = (size_t)(c + 1) * CHUNK;
            qr = *(const GAS v4u*)(GQ + (o + qrow) * 256 + qcs * 8); kr = *(const GAS v4u*)(GK + (o + qrow) * 256 + qcs * 8);
            vr0 = *(const GAS v4u*)(GV + (o + lrow) * 512 + cs0 * 8); vr1 = *(const GAS v4u*)(GV + (o + lrow) * 512 + cs1 * 8);
            if (tid < 256) gr = *(const GAS v4u*)(GA + o * 16 + (size_t)tid * 4); }
        LBAR();
        float cl[8]; float run = 0.f;
#pragma unroll
        for (int tt = 0; tt < 8; ++tt) { const int t = 8 * w + tt; float lg = bias;
#pragma unroll
            for (int q = 0; q < 4; ++q) { const f32x4 g4 = *(const LAS f32x4*)(lds + GAS_ + t * 64 + q * 16); lg += g4[0] * wa[4 * q] + g4[1] * wa[4 * q + 1] + g4[2] * wa[4 * q + 2] + g4[3] * wa[4 * q + 3]; }
            const float la = (fminf(lg, 0.f) - __logf(1.0f + __expf(-fabsf(lg)))) * (1.0f / 16.0f);
            run += la; cl[tt] = run; }
        *(LAS float*)(lds + TOT + (w * 64 + lane) * 4) = run;
        LBAR();
        float prefix = 0.f, last = 0.f;
#pragma unroll
        for (int g = 0; g < 8; ++g) { const float tv = *(const LAS float*)(lds + TOT + (g * 64 + lane) * 4); last += tv; if (g < w) prefix += tv; }
#pragma unroll
        for (int tt = 0; tt < 8; ++tt) { const int t = 8 * w + tt; const float cum = prefix + cl[tt];
            const float q = bf2f(*(const LAS unsigned short*)(lds + RQS + t * 128 + lane * 2)), k = bf2f(*(const LAS unsigned short*)(lds + RKS + t * 128 + lane * 2));
            *(LAS unsigned short*)(lds + QS + t * P144 + lane * 2) = (unsigned short)f2bf(q * __expf(cum));
            *(LAS unsigned short*)(lds + KS + t * P144 + lane * 2) = (unsigned short)f2bf(k * __expf(-cum));
            *(LAS unsigned short*)(lds + KTS + lane * P144 + t * 2) = (unsigned short)f2bf(k * __expf(last - cum)); }
        if (w == 0) *(LAS float*)(lds + DEC + lane * 4) = __expf(last);
        LBAR();
        f32x16 acc;
#pragma unroll
        for (int i = 0; i < 16; ++i) acc[i] = 0.f;
#pragma unroll
        for (int ks = 0; ks < 4; ++ks) acc = MFMA32(FRAG(QS, 32 * ib + r, P144, 32 * ks + 16 * hh), FRAG(STS, 32 * vb + r, P144, 32 * ks + 16 * hh), acc);
#pragma unroll
        for (int i = 0; i < 16; ++i) st[i] *= *(const LAS float*)(lds + DEC + (32 * ib + crow(i, hh)) * 4);
#pragma unroll
        for (int ks = 0; ks < 4; ++ks) st = MFMA32(FRAG(KTS, 32 * ib + r, P144, 32 * ks + 16 * hh), FRAG(VTS, 32 * vb + r, P144, 32 * ks + 16 * hh), st);
        if (w < 4) { const int sib = w >> 1, sjb = w & 1; f32x16 s;
#pragma unroll
            for (int i = 0; i < 16; ++i) s[i] = 0.f;
#pragma unroll
            for (int ks = 0; ks < 4; ++ks) s = MFMA32(FRAG(QS, 32 * sib + r, P144, 32 * ks + 16 * hh), FRAG(KS, 32 * sjb + r, P144, 32 * ks + 16 * hh), s);
            const int jj = 32 * sjb + r;
#pragma unroll
            for (int i = 0; i < 16; ++i) { const int ii = 32 * sib + crow(i, hh); const float p = (ii >= jj) ? s[i] : 0.f;
                *(LAS unsigned short*)(lds + PS + ii * P144 + jj * 2) = (unsigned short)f2bf(p); } }
        LBAR();
#pragma unroll
        for (int ks = 0; ks < 4; ++ks) acc = MFMA32(FRAG(PS, 32 * ib + r, P144, 32 * ks + 16 * hh), FRAG(VTS, 32 * vb + r, P144, 32 * ks + 16 * hh), acc);
        put_state_t(lds, STS, P144, 32 * vb + r, 32 * ib + 4 * hh, st);
#pragma unroll
        for (int i = 0; i < 16; ++i) *(LAS float*)(lds + OS + (32 * ib + crow(i, hh)) * 528 + (32 * vb + r) * 4) = acc[i];
        LBAR();
        norm_out<false>(lds, OS, YC + (size_t)(c * CHUNK) * 512, gnw + h * 128, tid);
        LBAR();
    }
}
__device__ __forceinline__ void mixer_phase(Frame& F, const Args& a, int layer) {
    const int bx = blockIdx.x;
    for (int ch = bx; ch < 64; ch += F.G) {
        if (ch < 32) ret_chain(F, a.in[I_RETGN] + layer * 512, ch >> 2, ch & 3);
        else gla_chain(F, a.in[I_WA2] + layer * 16 * 256, a.in[I_BA] + layer * 256, a.in[I_GLAGN] + layer * 512, (ch - 32) >> 2, (ch - 32) & 3);
    }
    if (F.G > 64) { if (bx >= 64) conv_rows(F, a.in[I_CONVW] + layer * 3 * 512, (bx - 64) * NWAVES + F.wave, (F.G - 64) * NWAVES); }
    else conv_rows(F, a.in[I_CONVW] + layer * 3 * 512, bx * NWAVES + F.wave, F.G * NWAVES);
}

__global__ void __launch_bounds__(NWAVES * 64, 2) fwd_megakernel(Args args) {
    extern __shared__ __attribute__((aligned(16))) unsigned char lds_raw[];
    Frame F;
    F.lds = (LAS unsigned char*)lds_raw;
    F.MISC = (volatile LAS unsigned*)(F.lds + MISC_OFF);
    F.tid = threadIdx.x; F.lane = F.tid & 63; F.wave = __builtin_amdgcn_readfirstlane(F.tid >> 6);
    F.G = gridDim.x; { const int bx = blockIdx.x; F.vcu = (F.G % 8 == 0) ? (bx % 8) * (F.G / 8) + bx / 8 : bx; }
    F.ws = args.ws; F.ctl = (gu32*)(args.ws + WS_CTL);
    for (int u = F.tid; u < (LDS_BYTES - LDSCTL_OFF) / 4; u += NWAVES * 64) ((LAS unsigned*)(F.lds + LDSCTL_OFF))[u] = 0u;
    __syncthreads();
    XcdBarrier bar; bar.bar = (unsigned*)(F.ctl + CW_BAR); bar.x = 0; bar.st = nullptr;
    if (N_LAUNCHES != PER_PHASE) bar = xcd_barrier_post((unsigned*)(F.ctl + CW_BAR), F.MISC + 8);
#define GRID_BAR() do { if (N_LAUNCHES != PER_PHASE) xcd_barrier(bar); } while (0)
    const int lo = args.ph_lo, hi = args.ph_hi;
#define IN(k) (lo <= (k) && (k) < hi)
#define SEAM(k) do { if (IN(k) && IN((k) + 1)) GRID_BAR(); } while (0)
    unsigned char* ws = args.ws;
    bf16* Hb = (bf16*)(ws + WS_H); bf16* H2b = (bf16*)(ws + WS_H2);

    if (IN(0)) { convert_layer(F, args, 0); rope_tables(F, args); rows_norm(F, args.in[I_X], args.in[I_NMIXPRE], Hb); }
    SEAM(0);
    for (int layer = 0; layer < DEPTH; ++layer) {
        const int p0 = 1 + PH_PER_LAYER * layer;
        const float* xin = (layer == 0) ? args.in[I_X] : args.out;
        unsigned char* ws = opaque(args.ws); bf16* Hb = (bf16*)(ws + WS_H); bf16* H2b = (bf16*)(ws + WS_H2);
        { int t_ = threadIdx.x; asm volatile("" : "+v"(t_)); F.tid = t_; F.lane = t_ & 63; F.wave = __builtin_amdgcn_readfirstlane(t_ >> 6); F.ws = ws; }
        if (IN(p0)) { pg8::Gemm g{Hb, (const bf16*)(ws + WS_WIN), M, NT_A * 256, D}; pg8::StaticOrder S; S.init(M, NT_A * 256, F.G, (int)blockIdx.x);
            EpiProj<0> E{ws, 0}; pg8::gemm_phase<EpiProj<0>, pg8::StaticOrder, true, true>(F.lds + RING_OFF, g, S, E); }
        SEAM(p0);
        if (IN(p0 + 1)) mixer_phase(F, args, layer);
        SEAM(p0 + 1);
        if (IN(p0 + 2)) { pg8::Gemm g{Hb, (const bf16*)(ws + WS_WIN) + (size_t)NT_A * 256 * 1024, M, NT_B * 256, D}; pg8::StaticOrder S; S.init(M, NT_B * 256, F.G, (int)blockIdx.x);
            EpiProj<0> E{ws, NT_A}; pg8::gemm_phase<EpiProj<0>, pg8::StaticOrder, true, true>(F.lds + RING_OFF, g, S, E); }
        SEAM(p0 + 2);
        if (IN(p0 + 3)) { pg8::Gemm g{(const bf16*)(ws + WS_Y), (const bf16*)(ws + WS_WABC), 3 * M, 3 * 1024, 512}; MergeOrder S; S.base.init(M, 1024, F.G, (int)blockIdx.x);
            EpiMerge E{(const bf16*)(ws + WS_GATES), Hb}; pg8::gemm_phase<EpiMerge, MergeOrder, true, true>(F.lds + RING_OFF, g, S, E); }
        SEAM(p0 + 3);
        if (IN(p0 + 4)) { pg8::Gemm g{Hb, (const bf16*)(ws + WS_WOUT), M, D, D}; pg8::StaticOrder S; S.init(M, D, F.G, (int)blockIdx.x);
            EpiF32 E{(float*)(ws + WS_MO), D}; pg8::gemm_phase<EpiF32, pg8::StaticOrder, true, true>(F.lds + RING_OFF, g, S, E); }
        SEAM(p0 + 4);
        if (IN(p0 + 5)) rows_update(F, xin, (const float*)(ws + WS_MO), args.in[I_NMIXPOST] + layer * D, args.out, args.in[I_NFFNPRE] + layer * D, H2b);
        SEAM(p0 + 5);
        if (IN(p0 + 6)) { pg8::Gemm g{H2b, (const bf16*)(ws + WS_WGU), M, 2 * DFF, D}; pg8::StaticOrder S; S.init(M, 2 * DFF, F.G, (int)blockIdx.x);
            EpiProj<1> E{ws, 0}; pg8::gemm_phase<EpiProj<1>, pg8::StaticOrder, true, true>(F.lds + RING_OFF, g, S, E); }
        SEAM(p0 + 6);
        if (IN(p0 + 7)) { pg8::Gemm g{(const bf16*)(ws + WS_ACT), (const bf16*)(ws + WS_WDN), M, D, DFF}; pg8::StaticOrder S; S.init(M, D, F.G, (int)blockIdx.x);
            EpiF32 E{(float*)(ws + WS_F), D}; pg8::gemm_phase<EpiF32, pg8::StaticOrder, true, true>(F.lds + RING_OFF, g, S, E); }
        SEAM(p0 + 7);
        if (IN(p0 + 8)) {
            if (layer + 1 < DEPTH) { convert_layer(F, args, layer + 1);
                rows_update(F, args.out, (const float*)(ws + WS_F), args.in[I_NFFNPOST] + layer * D, args.out, args.in[I_NMIXPRE] + (layer + 1) * D, Hb); }
            else rows_update(F, args.out, (const float*)(ws + WS_F), args.in[I_NFFNPOST] + layer * D, args.out, nullptr, nullptr);
        }
        if (layer + 1 < DEPTH) SEAM(p0 + 8);
    }
#undef IN
#undef SEAM
#undef GRID_BAR
}

extern "C" void kernel_launch(void* const* d_in, const int* in_sizes, int n_in, void* d_out, int out_size, void* d_ws, size_t ws_size, hipStream_t stream) {
    static int grid = 0;
    if (grid == 0) {
        if (n_in != 19 || in_sizes[0] != M * D || out_size != M * D || ws_size < WS_END) { fprintf(stderr, "kernel_launch: unexpected shapes (n_in %d, in0 %d, out %d, ws %zu)\n", n_in, n_in > 0 ? in_sizes[0] : -1, out_size, ws_size); grid = -1; return; }
        int dev = 0, cus = 0, per_cu = 0;
        if (hipGetDevice(&dev) != hipSuccess || hipDeviceGetAttribute(&cus, hipDeviceAttributeMultiprocessorCount, dev) != hipSuccess) { grid = -1; return; }
        if (hipFuncSetAttribute((const void*)fwd_megakernel, hipFuncAttributeMaxDynamicSharedMemorySize, LDS_BYTES) != hipSuccess) { fprintf(stderr, "kernel_launch: hipFuncSetAttribute failed\n"); grid = -1; return; }
        if (hipOccupancyMaxActiveBlocksPerMultiprocessor(&per_cu, (const void*)fwd_megakernel, NWAVES * 64, LDS_BYTES) != hipSuccess || per_cu < 1)
            fprintf(stderr, "kernel_launch: occupancy query reports %d workgroups per CU\n", per_cu);
        (void)hipGetLastError();
        grid = cus;
    }
    if (grid < 0) return;
    if (hipMemsetAsync((char*)d_ws + WS_CTL, 0, CTL_ZERO_BYTES, stream) != hipSuccess) return;
    Args a{};
    for (int i = 0; i < 19; ++i) a.in[i] = (const float*)d_in[i];
    a.out = (float*)d_out; a.ws = (unsigned char*)d_ws;
    if (N_LAUNCHES == 1) { a.ph_lo = 0; a.ph_hi = PER_PHASE; a.li = 0; hipLaunchKernelGGL(fwd_megakernel, dim3(grid), dim3(NWAVES * 64), LDS_BYTES, stream, a); }
    else for (int li = 0; li < PER_PHASE; ++li) { a.ph_lo = li; a.ph_hi = li + 1; a.li = li; hipLaunchKernelGGL(fwd_megakernel, dim3(grid), dim3(NWAVES * 64), LDS_BYTES, stream, a); }
}
```
